# Optimizing an MI355X kernel written in HIP

```python
import math
import jax
import jax.numpy as jnp
from jax import lax
import numpy as np

D_MODEL = 1024
BATCH = 8
SEQ = 2048
DEPTH = 2
DEC_BATCH = 128
DEC_SEQ = 1
PAST_LEN = 16384
PAGE_SIZE = 128

N_EVEN = (DEPTH + 1) // 2
N_ODD = DEPTH // 2
HALF = D_MODEL // 2

GLA_H = 4
GLA_DV = HALF // GLA_H
GLA_DK = GLA_DV // 2
GLA_KW = GLA_H * GLA_DK
GLA_VW = GLA_H * GLA_DV
GLA_LR = 16
GLA_TAU = 16.0
CHUNK = 64

LRU_W = HALF
LRU_H = 8
LRU_BW = LRU_W // LRU_H
CONV_W = 4
RG_C = 8.0

S5_W = HALF
S5_GH = 16
S5_G = S5_W // S5_GH
S5_P = 64

HG_H = 4
HG_D = HALF // HG_H
HG_W = HG_H * HG_D

D_FF = ((8 * D_MODEL // 3 + 255) // 256) * 256

EVEN_SPLITS = (GLA_KW, GLA_KW, GLA_VW, GLA_VW, GLA_LR, LRU_W, LRU_W)
ODD_SPLITS = (S5_W, HG_W, HG_W, HG_W, HG_W)
EVEN_IN = sum(EVEN_SPLITS)
ODD_IN = sum(ODD_SPLITS)
EVEN_OUT = GLA_VW + LRU_W
ODD_OUT = S5_W + HG_W

ALPHA = (2.0 * DEPTH) ** 0.25
BETA = (8.0 * DEPTH) ** -0.25
LN_EPS = 1e-5
RMS_EPS = 1e-6

kernel_name = 'hybrid_gla_rglru_s5_hgrn2_step'


def split_cols(z, sizes):
    idx = [int(s) for s in np.cumsum(sizes)[:-1]]
    return jnp.split(z, idx, axis=-1)


def layer_norm(x, g, b):
    xf = x.astype(jnp.float32)
    mu = jnp.mean(xf, axis=-1, keepdims=True)
    var = jnp.mean(jnp.square(xf - mu), axis=-1, keepdims=True)
    return (xf - mu) * lax.rsqrt(var + LN_EPS) * g + b


def rms_norm(x, g):
    xf = x.astype(jnp.float32)
    return xf * lax.rsqrt(jnp.mean(xf * xf, axis=-1, keepdims=True) + RMS_EPS) * g


def swiglu(h, w_in, w_out):
    gate, up = jnp.split(jnp.einsum('bld,df->blf', h, w_in), 2, axis=-1)
    return jnp.einsum('blf,fd->bld', jax.nn.silu(gate) * up, w_out)


def gated_linear_attention(q, k, v, log_a, s0):
    bsz, L = q.shape[0], q.shape[1]
    c = min(CHUNK, L)
    n = -(-L // c)
    pad = n * c - L

    def blocks(t):
        t = jnp.pad(t.astype(jnp.float32), [(0, 0), (0, pad)] + [(0, 0)] * (t.ndim - 2))
        return jnp.moveaxis(t.reshape((bsz, n, c) + t.shape[2:]), 1, 0)

    qb, kb, vb, gb = blocks(q), blocks(k), blocks(v), blocks(log_a)
    cum = jnp.cumsum(gb, axis=2)
    causal = jnp.tril(jnp.ones((c, c), dtype=bool))[:, :, None, None]

    def step(s, blk):
        qc, kc, vc, bc = blk
        rel = jnp.where(causal, bc[:, :, None] - bc[:, None, :], -jnp.inf)
        scores = jnp.einsum('btshk,bthk,bshk->bhts', jnp.exp(rel), qc, kc)
        last = bc[:, -1]
        o = (jnp.einsum('bhts,bshv->bthv', scores, vc)
             + jnp.einsum('bthk,bhkv->bthv', qc * jnp.exp(bc), s))
        s_new = (jnp.exp(last)[..., None] * s
                 + jnp.einsum('bshk,bshv->bhkv', kc * jnp.exp(last[:, None] - bc), vc))
        return s_new, o

    s_fin, ob = lax.scan(step, s0.astype(jnp.float32), (qb, kb, vb, cum))
    o = jnp.moveaxis(ob, 0, 1).reshape((bsz, n * c) + ob.shape[3:])[:, :L]
    return o, s_fin


def causal_depthwise_conv(buf, x, w, b):
    L = x.shape[1]
    xp = jnp.concatenate([buf, x], axis=1)
    y = b + xp[:, 0:L] * w[0]
    for j in range(1, CONV_W):
        y = y + xp[:, j:j + L] * w[j]
    return y, xp[:, xp.shape[1] - (CONV_W - 1):]


def s5_ssm(u, s_re, s_im, lam_re, lam_im, log_dt, b_re, b_im, c_re, c_im, d_skip):
    f32 = jnp.float32
    bsz, L = u.shape[0], u.shape[1]
    uf = u.astype(f32).reshape(bsz, L, S5_G, S5_GH)
    dt = jnp.exp(log_dt.astype(f32))[:, None]
    lr_, li_ = lam_re.astype(f32), lam_im.astype(f32)
    mag = jnp.exp(lr_ * dt)
    ab_re, ab_im = mag * jnp.cos(li_ * dt), mag * jnp.sin(li_ * dt)
    den = lr_ * lr_ + li_ * li_
    nr, ni = ab_re - 1.0, ab_im
    f_re = (nr * lr_ + ni * li_) / den
    f_im = (ni * lr_ - nr * li_) / den
    bb_re = f_re[..., None] * b_re - f_im[..., None] * b_im
    bb_im = f_re[..., None] * b_im + f_im[..., None] * b_re
    bu_re = jnp.einsum('blgh,gph->blgp', uf, bb_re)
    bu_im = jnp.einsum('blgh,gph->blgp', uf, bb_im)
    a_re = jnp.broadcast_to(ab_re, bu_re.shape)
    a_im = jnp.broadcast_to(ab_im, bu_re.shape)

    def combine(e1, e2):
        a1r, a1i, b1r, b1i = e1
        a2r, a2i, b2r, b2i = e2
        return (a1r * a2r - a1i * a2i, a1r * a2i + a1i * a2r,
                a2r * b1r - a2i * b1i + b2r, a2r * b1i + a2i * b1r + b2i)

    _, _, hr, hi = lax.associative_scan(combine, (a_re, a_im, bu_re, bu_im), axis=1)
    steps = jnp.arange(1, L + 1, dtype=f32)[:, None, None]
    pm = jnp.exp(lr_ * dt * steps)
    ang = li_ * dt * steps
    p_re, p_im = pm * jnp.cos(ang), pm * jnp.sin(ang)
    s0r, s0i = s_re.astype(f32)[:, None], s_im.astype(f32)[:, None]
    hr = hr + p_re * s0r - p_im * s0i
    hi = hi + p_re * s0i + p_im * s0r
    y = (jnp.einsum('ghp,blgp->blgh', c_re, hr) - jnp.einsum('ghp,blgp->blgh', c_im, hi)
         + d_skip.reshape(S5_G, S5_GH) * uf)
    return y.reshape(bsz, L, S5_W), hr[:, -1], hi[:, -1]


def even_mixer(h, s_gla, s_conv, s_lru, w_in, gla_w_lr, gla_b_lr, gla_norm_g,
               conv_w, conv_b, lru_w_r, lru_b_r, lru_w_i, lru_b_i, lru_lam, w_out):
    bsz, L = h.shape[0], h.shape[1]
    z = jnp.einsum('bld,de->ble', h, w_in).astype(jnp.float32)
    q, k, v, g, lr, xr, gr = split_cols(z, EVEN_SPLITS)
    log_alpha = jax.nn.log_sigmoid(jnp.einsum('blr,rk->blk', lr, gla_w_lr) + gla_b_lr) / GLA_TAU
    o, s_gla_new = gated_linear_attention(
        q.reshape(bsz, L, GLA_H, GLA_DK) * (GLA_DK ** -0.5),
        k.reshape(bsz, L, GLA_H, GLA_DK),
        v.reshape(bsz, L, GLA_H, GLA_DV),
        log_alpha.reshape(bsz, L, GLA_H, GLA_DK), s_gla)
    y_gla = rms_norm(o, gla_norm_g).reshape(bsz, L, GLA_VW) * jax.nn.silu(g)
    xc, s_conv_new = causal_depthwise_conv(s_conv.astype(jnp.float32), xr, conv_w, conv_b)
    xb = xc.reshape(bsz, L, LRU_H, LRU_BW)
    r = jax.nn.sigmoid(jnp.einsum('blhi,hij->blhj', xb, lru_w_r).reshape(bsz, L, LRU_W) + lru_b_r)
    i = jax.nn.sigmoid(jnp.einsum('blhi,hij->blhj', xb, lru_w_i).reshape(bsz, L, LRU_W) + lru_b_i)
    log_a = -RG_C * r * jax.nn.softplus(-lru_lam.astype(jnp.float32))
    u = jnp.sqrt(-jnp.expm1(2.0 * log_a)) * (i * xc)

    def lru_step(h_prev, inp):
        a_t, u_t = inp
        h_t = a_t * h_prev + u_t
        return h_t, h_t

    s_lru_new, hs = lax.scan(lru_step, s_lru.astype(jnp.float32),
                             (jnp.swapaxes(jnp.exp(log_a), 0, 1), jnp.swapaxes(u, 0, 1)))
    y_lru = jnp.swapaxes(hs, 0, 1) * jax.nn.gelu(gr)
    out = jnp.einsum('ble,ed->bld', jnp.concatenate([y_gla, y_lru], axis=-1), w_out)
    return out, s_gla_new, s_conv_new, s_lru_new


def odd_mixer(h, s_re, s_im, s_hg, lower_bound, w_in, lam_re, lam_im, log_dt, b_re, b_im,
              c_re, c_im, d_skip, w_glu, b_glu, hg_norm_g, w_out):
    bsz, L = h.shape[0], h.shape[1]
    z = jnp.einsum('bld,de->ble', h, w_in).astype(jnp.float32)
    u, q, f, i, g = split_cols(z, ODD_SPLITS)
    y, s_re_new, s_im_new = s5_ssm(u, s_re, s_im, lam_re, lam_im, log_dt, b_re, b_im,
                                   c_re, c_im, d_skip)
    y = jax.nn.gelu(y)
    y_s5 = y * jax.nn.sigmoid(jnp.einsum('ble,ef->blf', y, w_glu) + b_glu)
    forget = lower_bound + (1.0 - lower_bound) * jax.nn.sigmoid(f)
    hd = lambda t: t.reshape(bsz, L, HG_H, HG_D)
    o, s_hg_new = gated_linear_attention(hd(jax.nn.silu(q)), hd(1.0 - forget), hd(i),
                                         hd(jnp.log(forget)), s_hg)
    y_hg = rms_norm(o, hg_norm_g).reshape(bsz, L, HG_W) * jax.nn.silu(g)
    out = jnp.einsum('ble,ed->bld', jnp.concatenate([y_s5, y_hg], axis=-1), w_out)
    return out, s_re_new, s_im_new, s_hg_new


def setup_inputs(seed: int = 0) -> dict:
    key = jax.random.key(seed)
    ks = iter(jax.random.split(key, 64))
    f32 = jnp.float32

    def nrm(shape, scale):
        return jax.random.normal(next(ks), shape, f32) * scale

    x_prompt = nrm((BATCH, SEQ, D_MODEL), 1.0)
    x_sample = nrm((DEC_BATCH, DEC_SEQ, D_MODEL), 1.0)
    c_prompt = nrm((BATCH, D_MODEL), 1.0)
    c_sample = nrm((DEC_BATCH, D_MODEL), 1.0)
    state_gla = nrm((N_EVEN, DEC_BATCH, GLA_H, GLA_DK, GLA_DV), 1.0)
    state_rglru_conv = nrm((N_EVEN, DEC_BATCH, CONV_W - 1, LRU_W), 1.0)
    state_rglru_h = nrm((N_EVEN, DEC_BATCH, LRU_W), 0.5)
    state_s5_re = nrm((N_ODD, DEC_BATCH, S5_G, S5_P), 0.1)
    state_s5_im = nrm((N_ODD, DEC_BATCH, S5_G, S5_P), 0.1)
    state_hgrn = nrm((N_ODD, DEC_BATCH, HG_H, HG_D, HG_D), 0.4)

    ev_w_in = nrm((N_EVEN, D_MODEL, EVEN_IN), D_MODEL ** -0.5)
    ev_gla_w_lr = nrm((N_EVEN, GLA_LR, GLA_KW), GLA_LR ** -0.5)
    ev_gla_b_lr = nrm((N_EVEN, GLA_KW), 0.1)
    ev_gla_norm_g = 1.0 + nrm((N_EVEN, GLA_DV), 0.1)
    ev_conv_w = nrm((N_EVEN, CONV_W, LRU_W), CONV_W ** -0.5)
    ev_conv_b = nrm((N_EVEN, LRU_W), 0.01)
    ev_lru_w_r = nrm((N_EVEN, LRU_H, LRU_BW, LRU_BW), LRU_BW ** -0.5)
    ev_lru_b_r = nrm((N_EVEN, LRU_W), 0.01)
    ev_lru_w_i = nrm((N_EVEN, LRU_H, LRU_BW, LRU_BW), LRU_BW ** -0.5)
    ev_lru_b_i = nrm((N_EVEN, LRU_W), 0.01)
    a_c = jax.random.uniform(next(ks), (N_EVEN, LRU_W), f32, minval=0.9, maxval=0.999)
    sig = a_c ** (1.0 / RG_C)
    ev_lru_lam = jnp.log(sig) - jnp.log1p(-sig)
    ev_w_out = nrm((N_EVEN, EVEN_OUT, D_MODEL), BETA * EVEN_OUT ** -0.5)

    od_w_in = nrm((N_ODD, D_MODEL, ODD_IN), D_MODEL ** -0.5)
    od_s5_lam_re = -0.5 + nrm((N_ODD, S5_G, S5_P), 0.01)
    od_s5_lam_im = jnp.pi * jnp.arange(S5_P, dtype=f32) + nrm((N_ODD, S5_G, S5_P), 0.01)
    od_s5_log_dt = jax.random.uniform(next(ks), (N_ODD, S5_G), f32,
                                      minval=math.log(0.001), maxval=math.log(0.1))
    od_s5_b_re = nrm((N_ODD, S5_G, S5_P, S5_GH), (2.0 * S5_GH) ** -0.5)
    od_s5_b_im = nrm((N_ODD, S5_G, S5_P, S5_GH), (2.0 * S5_GH) ** -0.5)
    od_s5_c_re = nrm((N_ODD, S5_G, S5_GH, S5_P), S5_P ** -0.5)
    od_s5_c_im = nrm((N_ODD, S5_G, S5_GH, S5_P), S5_P ** -0.5)
    od_s5_d = nrm((N_ODD, S5_W), 0.5)
    od_s5_w_glu = nrm((N_ODD, S5_W, S5_W), S5_W ** -0.5)
    od_s5_b_glu = nrm((N_ODD, S5_W), 0.01)
    hg_lb_logits = nrm((DEPTH, HG_W), 0.5)
    od_hg_norm_g = 1.0 + nrm((N_ODD, HG_D), 0.1)
    od_w_out = nrm((N_ODD, ODD_OUT, D_MODEL), BETA * ODD_OUT ** -0.5)

    w_ada = nrm((DEPTH, D_MODEL, 6 * D_MODEL), 0.5 * D_MODEL ** -0.5)
    b_ada = nrm((DEPTH, 6 * D_MODEL), 0.01)
    ln_g = 1.0 + nrm((DEPTH, 2, D_MODEL), 0.1)
    ln_b = nrm((DEPTH, 2, D_MODEL), 0.01)
    ffn_w_in = nrm((DEPTH, D_MODEL, 2 * D_FF), D_MODEL ** -0.5)
    ffn_w_out = nrm((DEPTH, D_FF, D_MODEL), BETA * D_FF ** -0.5)

    return {
        'x_prompt': x_prompt, 'x_sample': x_sample, 'c_prompt': c_prompt, 'c_sample': c_sample,
        'state_gla': state_gla, 'state_rglru_conv': state_rglru_conv,
        'state_rglru_h': state_rglru_h, 'state_s5_re': state_s5_re,
        'state_s5_im': state_s5_im, 'state_hgrn': state_hgrn,
        'ev_w_in': ev_w_in, 'ev_gla_w_lr': ev_gla_w_lr, 'ev_gla_b_lr': ev_gla_b_lr,
        'ev_gla_norm_g': ev_gla_norm_g, 'ev_conv_w': ev_conv_w, 'ev_conv_b': ev_conv_b,
        'ev_lru_w_r': ev_lru_w_r, 'ev_lru_b_r': ev_lru_b_r, 'ev_lru_w_i': ev_lru_w_i,
        'ev_lru_b_i': ev_lru_b_i, 'ev_lru_lam': ev_lru_lam, 'ev_w_out': ev_w_out,
        'od_w_in': od_w_in, 'od_s5_lam_re': od_s5_lam_re, 'od_s5_lam_im': od_s5_lam_im,
        'od_s5_log_dt': od_s5_log_dt, 'od_s5_b_re': od_s5_b_re, 'od_s5_b_im': od_s5_b_im,
        'od_s5_c_re': od_s5_c_re, 'od_s5_c_im': od_s5_c_im, 'od_s5_d': od_s5_d,
        'od_s5_w_glu': od_s5_w_glu, 'od_s5_b_glu': od_s5_b_glu,
        'hg_lb_logits': hg_lb_logits, 'od_hg_norm_g': od_hg_norm_g, 'od_w_out': od_w_out,
        'w_ada': w_ada, 'b_ada': b_ada, 'ln_g': ln_g, 'ln_b': ln_b,
        'ffn_w_in': ffn_w_in, 'ffn_w_out': ffn_w_out,
    }


def reference(x_prompt, x_sample, c_prompt, c_sample,
              state_gla, state_rglru_conv, state_rglru_h, state_s5_re, state_s5_im, state_hgrn,
              ev_w_in, ev_gla_w_lr, ev_gla_b_lr, ev_gla_norm_g, ev_conv_w, ev_conv_b,
              ev_lru_w_r, ev_lru_b_r, ev_lru_w_i, ev_lru_b_i, ev_lru_lam, ev_w_out,
              od_w_in, od_s5_lam_re, od_s5_lam_im, od_s5_log_dt, od_s5_b_re, od_s5_b_im,
              od_s5_c_re, od_s5_c_im, od_s5_d, od_s5_w_glu, od_s5_b_glu,
              hg_lb_logits, od_hg_norm_g, od_w_out,
              w_ada, b_ada, ln_g, ln_b, ffn_w_in, ffn_w_out):
    f32 = jnp.float32
    sm = jax.nn.softmax(hg_lb_logits.astype(f32), axis=0)
    lower_bounds = jnp.cumsum(sm, axis=0) - sm[0]

    def run(x, c, s_gla, s_conv, s_lru, s_re, s_im, s_hg):
        x = x.astype(f32)
        cond = jax.nn.silu(c.astype(f32))
        n_gla, n_conv, n_lru, n_re, n_im, n_hg = [], [], [], [], [], []
        for l in range(DEPTH):
            mod = jnp.einsum('bd,de->be', cond, w_ada[l]) + b_ada[l]
            sh_m, sc_m, gt_m, sh_f, sc_f, gt_f = [m[:, None, :] for m in jnp.split(mod, 6, axis=-1)]
            h = x * (1.0 + sc_m) + sh_m
            if l % 2 == 0:
                e = l // 2
                out, t1, t2, t3 = even_mixer(
                    h, s_gla[e], s_conv[e], s_lru[e], ev_w_in[e], ev_gla_w_lr[e], ev_gla_b_lr[e],
                    ev_gla_norm_g[e], ev_conv_w[e], ev_conv_b[e], ev_lru_w_r[e], ev_lru_b_r[e],
                    ev_lru_w_i[e], ev_lru_b_i[e], ev_lru_lam[e], ev_w_out[e])
                n_gla.append(t1)
                n_conv.append(t2)
                n_lru.append(t3)
            else:
                o = l // 2
                out, t1, t2, t3 = odd_mixer(
                    h, s_re[o], s_im[o], s_hg[o], lower_bounds[l], od_w_in[o], od_s5_lam_re[o],
                    od_s5_lam_im[o], od_s5_log_dt[o], od_s5_b_re[o], od_s5_b_im[o], od_s5_c_re[o],
                    od_s5_c_im[o], od_s5_d[o], od_s5_w_glu[o], od_s5_b_glu[o], od_hg_norm_g[o],
                    od_w_out[o])
                n_re.append(t1)
                n_im.append(t2)
                n_hg.append(t3)
            x = layer_norm(ALPHA * x + (1.0 + gt_m) * out, ln_g[l, 0], ln_b[l, 0])
            h = x * (1.0 + sc_f) + sh_f
            x = layer_norm(ALPHA * x + (1.0 + gt_f) * swiglu(h, ffn_w_in[l], ffn_w_out[l]),
                           ln_g[l, 1], ln_b[l, 1])
        return (x, jnp.stack(n_gla), jnp.stack(n_conv), jnp.stack(n_lru),
                jnp.stack(n_re), jnp.stack(n_im), jnp.stack(n_hg))

    bp = x_prompt.shape[0]
    zeros = lambda shape: jnp.zeros(shape, f32)
    y_p, gla_p, conv_p, lru_p, re_p, im_p, hg_p = run(
        x_prompt, c_prompt,
        zeros((N_EVEN, bp, GLA_H, GLA_DK, GLA_DV)), zeros((N_EVEN, bp, CONV_W - 1, LRU_W)),
        zeros((N_EVEN, bp, LRU_W)), zeros((N_ODD, bp, S5_G, S5_P)),
        zeros((N_ODD, bp, S5_G, S5_P)), zeros((N_ODD, bp, HG_H, HG_D, HG_D)))
    y_s, gla_s, conv_s, lru_s, re_s, im_s, hg_s = run(
        x_sample, c_sample, state_gla, state_rglru_conv, state_rglru_h,
        state_s5_re, state_s5_im, state_hgrn)
    return (y_p.astype(x_prompt.dtype), y_s.astype(x_sample.dtype), gla_p, gla_s, conv_p, conv_s,
            lru_p, lru_s, re_p, re_s, im_p, im_s, hg_p, hg_s)
```

```cpp
#include <hip/hip_runtime.h>
#include <cstdint>
#include <cstdio>

typedef unsigned short bf16_t;
typedef short bf16x8 __attribute__((ext_vector_type(8)));
typedef float f32x4 __attribute__((ext_vector_type(4)));

__device__ __forceinline__ float bf2f(bf16_t h) { return __uint_as_float(((unsigned)h) << 16); }
__device__ __forceinline__ bf16_t f2bf(float f) { unsigned u = __float_as_uint(f); return (bf16_t)((u + 0x7fffu + ((u >> 16) & 1u)) >> 16); }
__device__ __forceinline__ float sigmoidf_(float x) { return 1.f / (1.f + expf(-x)); }
__device__ __forceinline__ float siluf_(float x) { return x / (1.f + expf(-x)); }
__device__ __forceinline__ float softplusf_(float x) { return log1pf(expf(-fabsf(x))) + fmaxf(x, 0.f); }
__device__ __forceinline__ float geluf_(float x) { return 0.5f * x * (1.f + tanhf(0.7978845608028654f * (x + 0.044715f * x * x * x))); }

constexpr int D = 1024, SEQ = 2048, NB = 8, NS = 128;
constexpr int MP = NB * SEQ;
constexpr int MT = MP + NS;
constexpr int MPAD = 16640;
constexpr int NSEQ = NB + NS;
constexpr int DFF = 2816;
constexpr int LDZ = 2816;
constexpr int Z0_Q = 0, Z0_K = 256, Z0_V = 512, Z0_G = 1024, Z0_XR = 1536, Z0_GR = 2048, Z0_LR = 2560;
constexpr int Z1_U = 0, Z1_Q = 512, Z1_F = 1024, Z1_I = 1536, Z1_G = 2048;
constexpr int NIN0 = 2816, NIN1 = 2560;
constexpr float ALPHA = 1.4142135623730951f;
constexpr float LN_EPS = 1e-5f, RMS_EPS = 1e-6f;
constexpr int MOD_SH_M = 0, MOD_SC_M = 1024, MOD_GT_M = 2048, MOD_SH_F = 3072, MOD_SC_F = 4096, MOD_GT_F = 5120;

constexpr size_t O_Y = 0;
constexpr size_t O_GLA_P = (size_t)MT * D;
constexpr size_t O_GLA_S = O_GLA_P + (size_t)NB * 4 * 64 * 128;
constexpr size_t O_CONV_P = O_GLA_S + (size_t)NS * 4 * 64 * 128;
constexpr size_t O_CONV_S = O_CONV_P + (size_t)NB * 3 * 512;
constexpr size_t O_LRU_P = O_CONV_S + (size_t)NS * 3 * 512;
constexpr size_t O_LRU_S = O_LRU_P + (size_t)NB * 512;
constexpr size_t O_RE_P = O_LRU_S + (size_t)NS * 512;
constexpr size_t O_RE_S = O_RE_P + (size_t)NB * 32 * 64;
constexpr size_t O_IM_P = O_RE_S + (size_t)NS * 32 * 64;
constexpr size_t O_IM_S = O_IM_P + (size_t)NB * 32 * 64;
constexpr size_t O_HG_P = O_IM_S + (size_t)NS * 32 * 64;
constexpr size_t O_HG_S = O_HG_P + (size_t)NB * 4 * 128 * 128;
constexpr size_t O_END = O_HG_S + (size_t)NS * 4 * 128 * 128;

constexpr size_t MiB = 1u << 20;
constexpr size_t WS_CTL = 0;
constexpr size_t WS_WIN0 = 1 * MiB;
constexpr size_t WS_WOUT0 = 7 * MiB;
constexpr size_t WS_WIN1 = 9 * MiB;
constexpr size_t WS_WOUT1 = 14 * MiB;
constexpr size_t WS_WGLU = 16 * MiB;
constexpr size_t WS_WLRU = 16 * MiB + 512 * 1024;
constexpr size_t WS_MISC = 17 * MiB;
constexpr size_t WS_FFNIN = 18 * MiB;
constexpr size_t WS_FFNOUT = 40 * MiB;
constexpr size_t WS_MOD = 51 * MiB;
constexpr size_t WS_XNY = 58 * MiB;
constexpr size_t WS_Z = 91 * MiB;
constexpr size_t WS_SCR = 181 * MiB;
constexpr size_t WS_END = 256 * MiB;

__device__ __forceinline__ int mod_row(int row) { return row < MP ? (row >> 11) : (row < MT ? NB + (row - MP) : NSEQ - 1); }

__device__ __forceinline__ int srccol(int n, int mode, int Nsrc) {
    if (mode == 0) return n < Nsrc ? n : -1;
    if (mode == 1) { if (n < 1536) return n; if (n < 2560) return n + 16; if (n < 2576) return n - 2560 + 1536; return -1; }
    const int pn = n >> 8, w = n & 255; return w < 128 ? 128 * pn + w : DFF + 128 * pn + (w - 128);
}
__global__ __launch_bounds__(256) void k_prep_w(const float* __restrict__ W, int K, int Nsrc, bf16_t* __restrict__ Wt, int Ndst, int mode) {
    __shared__ float tile[32][33];
    const int nb = Ndst / 32, kb = K / 32;
    for (int it = blockIdx.x; it < nb * kb; it += gridDim.x) {
        const int n0 = (it % nb) * 32, k0 = (it / nb) * 32;
        const int tx = threadIdx.x & 31, ty = threadIdx.x >> 5;
        for (int i = ty; i < 32; i += 8) { const int sc = srccol(n0 + tx, mode, Nsrc); tile[i][tx] = sc >= 0 ? W[(size_t)(k0 + i) * Nsrc + sc] : 0.f; }
        __syncthreads();
        for (int i = ty; i < 32; i += 8) Wt[(size_t)(n0 + i) * K + k0 + tx] = f2bf(tile[tx][i]);
        __syncthreads();
    }
}
__global__ void k_prep_lru(const float* __restrict__ wr, const float* __restrict__ wi, bf16_t* __restrict__ out) {
    const int idx = blockIdx.x * blockDim.x + threadIdx.x;
    if (idx >= 2 * 8 * 64 * 64) return;
    const int which = idx / (8 * 64 * 64), r = idx % (8 * 64 * 64), hb = r / 4096, j = (r / 64) % 64, i = r % 64;
    const float* w = which ? wi : wr;
    out[idx] = f2bf(w[hb * 4096 + i * 64 + j]);
}
__global__ __launch_bounds__(256) void k_mod(const float* __restrict__ cp, const float* __restrict__ cs, const float* __restrict__ wada, const float* __restrict__ bada, float* __restrict__ mod) {
    __shared__ float sc[8][1024];
    const int l = blockIdx.z, r0 = blockIdx.y * 8, e = blockIdx.x * 256 + threadIdx.x;
    for (int i = threadIdx.x; i < 8 * 1024; i += 256) { const int rr = r0 + (i >> 10), d = i & 1023; const float c = rr < NB ? cp[rr * 1024 + d] : cs[(rr - NB) * 1024 + d]; sc[i >> 10][d] = siluf_(c); }
    __syncthreads();
    float acc[8] = {0, 0, 0, 0, 0, 0, 0, 0};
    const float* w = wada + (size_t)l * 1024 * 6144 + e;
    for (int d = 0; d < 1024; ++d) { const float wv = w[(size_t)d * 6144];
#pragma unroll
        for (int i = 0; i < 8; ++i) acc[i] += sc[i][d] * wv; }
    for (int i = 0; i < 8; ++i) mod[((size_t)l * NSEQ + r0 + i) * 6144 + e] = acc[i] + bada[l * 6144 + e];
}
__global__ __launch_bounds__(256) void k_modulate0(const float* __restrict__ xp, const float* __restrict__ xs, const float* __restrict__ mod, float* __restrict__ X, bf16_t* __restrict__ XN) {
    const int row = blockIdx.x;
    const float* m = mod + (size_t)mod_row(row) * 6144;
    for (int d = threadIdx.x; d < 1024; d += 256) {
        if (row < MT) { const float x = row < MP ? xp[(size_t)row * 1024 + d] : xs[(size_t)(row - MP) * 1024 + d];
            X[(size_t)row * 1024 + d] = x; XN[(size_t)row * 1024 + d] = f2bf(x * (1.f + m[MOD_SC_M + d]) + m[MOD_SH_M + d]); }
        else XN[(size_t)row * 1024 + d] = 0;
    }
}
template <int MODE>
__global__ __launch_bounds__(256) void k_gemm_naive(const bf16_t* __restrict__ A, const bf16_t* __restrict__ Wt, void* __restrict__ out, int M, int N, int K, int ldo) {
    const int wave = (blockIdx.x * 256 + threadIdx.x) >> 6, lane = threadIdx.x & 63;
    const int nItemsN = N / 32; const int mi = wave / nItemsN, ni = wave % nItemsN;
    if (mi * 32 >= M) return;
    const int m0 = mi * 32; int nA, nB;
    if (MODE == 1) { const int pn = ni >> 3, sub = ni & 7; nA = pn * 256 + sub * 16; nB = nA + 128; } else { nA = ni * 32; nB = nA + 16; }
    f32x4 acc[2][2];
    for (int i = 0; i < 2; ++i) for (int j = 0; j < 2; ++j) acc[i][j] = (f32x4){0.f, 0.f, 0.f, 0.f};
    const int r = lane & 15, q = lane >> 4;
    const bf16_t* a0 = A + (size_t)(m0 + r) * K + q * 8; const bf16_t* a1 = a0 + (size_t)16 * K;
    const bf16_t* b0 = Wt + (size_t)(nA + r) * K + q * 8; const bf16_t* b1 = Wt + (size_t)(nB + r) * K + q * 8;
    for (int k0 = 0; k0 < K; k0 += 32) {
        const bf16x8 fa0 = *(const bf16x8*)(a0 + k0), fa1 = *(const bf16x8*)(a1 + k0), fb0 = *(const bf16x8*)(b0 + k0), fb1 = *(const bf16x8*)(b1 + k0);
        acc[0][0] = __builtin_amdgcn_mfma_f32_16x16x32_bf16(fa0, fb0, acc[0][0], 0, 0, 0);
        acc[0][1] = __builtin_amdgcn_mfma_f32_16x16x32_bf16(fa0, fb1, acc[0][1], 0, 0, 0);
        acc[1][0] = __builtin_amdgcn_mfma_f32_16x16x32_bf16(fa1, fb0, acc[1][0], 0, 0, 0);
        acc[1][1] = __builtin_amdgcn_mfma_f32_16x16x32_bf16(fa1, fb1, acc[1][1], 0, 0, 0);
    }
    for (int i = 0; i < 2; ++i) for (int jj = 0; jj < 4; ++jj) {
        const int row = m0 + 16 * i + 4 * q + jj;
        if (MODE == 1) { const int pn = ni >> 3, sub = ni & 7; const float g = acc[i][0][jj], u = acc[i][1][jj];
            ((bf16_t*)out)[(size_t)row * ldo + 128 * pn + 16 * sub + r] = f2bf(siluf_(g) * u); }
        else for (int j = 0; j < 2; ++j) { const int col = (j ? nB : nA) + r;
            if (MODE == 0) ((bf16_t*)out)[(size_t)row * ldo + col] = f2bf(acc[i][j][jj]); else ((float*)out)[(size_t)row * ldo + col] = acc[i][j][jj]; }
    }
}
__global__ __launch_bounds__(256) void k_ln_naive(const float* __restrict__ TMP, float* __restrict__ X, const float* __restrict__ modl, int gt_off, const float* __restrict__ lng, const float* __restrict__ lnb,
                                                  bf16_t* __restrict__ XN, const float* __restrict__ modn, int sc_off, int sh_off) {
    __shared__ float red[2][4];
    const int row = blockIdx.x; if (row >= MT) return;
    const int mr = mod_row(row); const float* gt = modl + (size_t)mr * 6144 + gt_off;
    float v[4]; float s = 0.f;
    for (int i = 0; i < 4; ++i) { const int d = threadIdx.x + 256 * i; v[i] = ALPHA * X[(size_t)row * 1024 + d] + (1.f + gt[d]) * TMP[(size_t)row * 1024 + d]; s += v[i]; }
    for (int o = 32; o; o >>= 1) s += __shfl_xor(s, o);
    if ((threadIdx.x & 63) == 0) red[0][threadIdx.x >> 6] = s;
    __syncthreads();
    const float mean = (red[0][0] + red[0][1] + red[0][2] + red[0][3]) * (1.f / 1024.f);
    float q = 0.f; for (int i = 0; i < 4; ++i) { const float dd = v[i] - mean; q += dd * dd; }
    for (int o = 32; o; o >>= 1) q += __shfl_xor(q, o);
    if ((threadIdx.x & 63) == 0) red[1][threadIdx.x >> 6] = q;
    __syncthreads();
    const float rstd = rsqrtf((red[1][0] + red[1][1] + red[1][2] + red[1][3]) * (1.f / 1024.f) + LN_EPS);
    for (int i = 0; i < 4; ++i) { const int d = threadIdx.x + 256 * i; const float xn = (v[i] - mean) * rstd * lng[d] + lnb[d];
        X[(size_t)row * 1024 + d] = xn;
        if (modn) { const float* m = modn + (size_t)mr * 6144; XN[(size_t)row * 1024 + d] = f2bf(xn * (1.f + m[sc_off + d]) + m[sh_off + d]); } }
}

struct MixP {
    const bf16_t* Z; bf16_t* Y; float* out;
    const float *st_gla, *st_conv, *st_lru, *st_re, *st_im, *st_hg;
    const float *wlr, *blr, *gnorm, *convw, *convb, *wr, *br, *wi, *bi, *lam;
    const float *lam_re, *lam_im, *log_dt, *b_re, *b_im, *c_re, *c_im, *dskip, *wglu, *bglu, *lblog, *hgnorm;
    float* ypre;
};
template <int DK, int LAYER>
__global__ __launch_bounds__(128) void k_gla_naive(MixP p) {
    __shared__ float sq[DK], sk[DK], sa[DK]; __shared__ float red[2];
    const int seq = blockIdx.x >> 2, h = blockIdx.x & 3, v = threadIdx.x;
    const int L = seq < NB ? SEQ : 1; const int row0 = seq < NB ? seq * SEQ : MP + (seq - NB);
    float S[DK];
    const float* st = LAYER == 0 ? p.st_gla : p.st_hg;
    for (int k = 0; k < DK; ++k) S[k] = seq < NB ? 0.f : st[(((size_t)(seq - NB) * 4 + h) * DK + k) * 128 + v];
    float lb = 0.f;
    if (LAYER == 1 && v < DK) { const float l0 = p.lblog[h * 128 + v], l1 = p.lblog[512 + h * 128 + v]; lb = 1.f / (1.f + expf(l0 - l1)); }
    const float gn = (LAYER == 0 ? p.gnorm : p.hgnorm)[v];
    for (int t = 0; t < L; ++t) {
        const bf16_t* z = p.Z + (size_t)(row0 + t) * LDZ;
        if (v < DK) {
            if (LAYER == 0) {
                sq[v] = bf2f(z[Z0_Q + h * 64 + v]) * 0.125f; sk[v] = bf2f(z[Z0_K + h * 64 + v]);
                float x = p.blr[h * 64 + v];
                for (int r = 0; r < 16; ++r) x += bf2f(z[Z0_LR + r]) * p.wlr[r * 256 + h * 64 + v];
                sa[v] = expf(-softplusf_(-x) * (1.f / 16.f));
            } else {
                sq[v] = siluf_(bf2f(z[Z1_Q + h * 128 + v]));
                const float forget = lb + (1.f - lb) * sigmoidf_(bf2f(z[Z1_F + h * 128 + v]));
                sk[v] = 1.f - forget; sa[v] = forget;
            }
        }
        __syncthreads();
        const float vv = bf2f(z[(LAYER == 0 ? Z0_V : Z1_I) + h * 128 + v]);
        float o = 0.f;
#pragma unroll
        for (int k = 0; k < DK; ++k) { S[k] = sa[k] * S[k] + sk[k] * vv; o += sq[k] * S[k]; }
        float s2 = o * o;
        for (int off = 32; off; off >>= 1) s2 += __shfl_xor(s2, off);
        if ((v & 63) == 0) red[v >> 6] = s2;
        __syncthreads();
        const float ms = (red[0] + red[1]) * (1.f / 128.f);
        const float g = bf2f(z[(LAYER == 0 ? Z0_G : Z1_G) + h * 128 + v]);
        p.Y[(size_t)(row0 + t) * 1024 + (LAYER == 0 ? 0 : 512) + h * 128 + v] = f2bf(o * rsqrtf(ms + RMS_EPS) * gn * siluf_(g));
        __syncthreads();
    }
    float* so = p.out + (LAYER == 0 ? (seq < NB ? O_GLA_P : O_GLA_S) : (seq < NB ? O_HG_P : O_HG_S));
    const int sidx = seq < NB ? seq : seq - NB;
    for (int k = 0; k < DK; ++k) so[(((size_t)sidx * 4 + h) * DK + k) * 128 + v] = S[k];
}
__global__ __launch_bounds__(64) void k_lru_naive(MixP p) {
    __shared__ float sx[64];
    const int seq = blockIdx.x >> 3, hb = blockIdx.x & 7, j = threadIdx.x, ch = hb * 64 + j;
    const int L = seq < NB ? SEQ : 1; const int row0 = seq < NB ? seq * SEQ : MP + (seq - NB);
    float x3 = 0.f, x2 = 0.f, x1 = 0.f, h = 0.f;
    if (seq >= NB) { const float* c = p.st_conv + (size_t)(seq - NB) * 3 * 512; x3 = c[ch]; x2 = c[512 + ch]; x1 = c[1024 + ch]; h = p.st_lru[(size_t)(seq - NB) * 512 + ch]; }
    const float w0 = p.convw[ch], w1 = p.convw[512 + ch], w2 = p.convw[1024 + ch], w3 = p.convw[1536 + ch], cb = p.convb[ch];
    const float sp = softplusf_(-p.lam[ch]), brr = p.br[ch], bii = p.bi[ch];
    for (int t = 0; t < L; ++t) {
        const bf16_t* z = p.Z + (size_t)(row0 + t) * LDZ;
        const float x0 = bf2f(z[Z0_XR + ch]);
        const float xc = cb + w0 * x3 + w1 * x2 + w2 * x1 + w3 * x0;
        x3 = x2; x2 = x1; x1 = x0;
        sx[j] = xc; __syncthreads();
        float ar = brr, ai = bii;
        for (int i = 0; i < 64; ++i) { ar += sx[i] * p.wr[hb * 4096 + i * 64 + j]; ai += sx[i] * p.wi[hb * 4096 + i * 64 + j]; }
        const float r = sigmoidf_(ar), ig = sigmoidf_(ai);
        const float log_a = -8.f * r * sp;
        const float u = sqrtf(-expm1f(2.f * log_a)) * (ig * xc);
        h = expf(log_a) * h + u;
        p.Y[(size_t)(row0 + t) * 1024 + 512 + ch] = f2bf(h * geluf_(bf2f(z[Z0_GR + ch])));
        __syncthreads();
    }
    const int sidx = seq < NB ? seq : seq - NB;
    p.out[(seq < NB ? O_LRU_P : O_LRU_S) + (size_t)sidx * 512 + ch] = h;
    float* co = p.out + (seq < NB ? O_CONV_P : O_CONV_S) + (size_t)sidx * 3 * 512;
    co[ch] = x3; co[512 + ch] = x2; co[1024 + ch] = x1;
}
__global__ __launch_bounds__(64) void k_s5_naive(MixP p) {
    __shared__ float su[16], shr[64], shi[64];
    const int seq = blockIdx.x >> 5, g = blockIdx.x & 31, pp = threadIdx.x;
    const int L = seq < NB ? SEQ : 1; const int row0 = seq < NB ? seq * SEQ : MP + (seq - NB);
    const float dt = expf(p.log_dt[g]), lr = p.lam_re[g * 64 + pp], li = p.lam_im[g * 64 + pp];
    const float mag = expf(lr * dt), abr = mag * cosf(li * dt), abi = mag * sinf(li * dt);
    const float den = lr * lr + li * li, nr = abr - 1.f, ni = abi;
    const float fre = (nr * lr + ni * li) / den, fim = (ni * lr - nr * li) / den;
    float bbr[16], bbi[16];
    for (int hh = 0; hh < 16; ++hh) { const float br = p.b_re[(g * 64 + pp) * 16 + hh], bi = p.b_im[(g * 64 + pp) * 16 + hh]; bbr[hh] = fre * br - fim * bi; bbi[hh] = fre * bi + fim * br; }
    float hr = 0.f, hi = 0.f;
    if (seq >= NB) { hr = p.st_re[((size_t)(seq - NB) * 32 + g) * 64 + pp]; hi = p.st_im[((size_t)(seq - NB) * 32 + g) * 64 + pp]; }
    for (int t = 0; t < L; ++t) {
        const bf16_t* z = p.Z + (size_t)(row0 + t) * LDZ;
        if (pp < 16) su[pp] = bf2f(z[Z1_U + g * 16 + pp]);
        __syncthreads();
        float bur = 0.f, bui = 0.f;
        for (int hh = 0; hh < 16; ++hh) { bur += bbr[hh] * su[hh]; bui += bbi[hh] * su[hh]; }
        const float nhr = abr * hr - abi * hi + bur, nhi = abr * hi + abi * hr + bui;
        hr = nhr; hi = nhi; shr[pp] = hr; shi[pp] = hi;
        __syncthreads();
        if (pp < 16) { float y = p.dskip[g * 16 + pp] * su[pp];
            for (int q = 0; q < 64; ++q) y += p.c_re[(g * 16 + pp) * 64 + q] * shr[q] - p.c_im[(g * 16 + pp) * 64 + q] * shi[q];
            p.ypre[(size_t)(row0 + t) * 512 + g * 16 + pp] = geluf_(y); }
        __syncthreads();
    }
    const int sidx = seq < NB ? seq : seq - NB;
    p.out[(seq < NB ? O_RE_P : O_RE_S) + ((size_t)sidx * 32 + g) * 64 + pp] = hr;
    p.out[(seq < NB ? O_IM_P : O_IM_S) + ((size_t)sidx * 32 + g) * 64 + pp] = hi;
}
__global__ __launch_bounds__(256) void k_glu_naive(MixP p) {
    __shared__ float sy[8][512];
    const int r0 = blockIdx.x * 8;
    for (int i = threadIdx.x; i < 8 * 512; i += 256) sy[i >> 9][i & 511] = p.ypre[(size_t)(r0 + (i >> 9)) * 512 + (i & 511)];
    __syncthreads();
    for (int f = threadIdx.x; f < 512; f += 256) {
        float acc[8]; for (int i = 0; i < 8; ++i) acc[i] = p.bglu[f];
        for (int e = 0; e < 512; ++e) { const float w = p.wglu[e * 512 + f]; for (int i = 0; i < 8; ++i) acc[i] += sy[i][e] * w; }
        for (int i = 0; i < 8; ++i) p.Y[(size_t)(r0 + i) * 1024 + f] = f2bf(sy[i][f] * sigmoidf_(acc[i]));
    }
}

extern "C" void kernel_launch(void* const* d_in, const int* in_sizes, int n_in, void* d_out, int out_size, void* d_ws, size_t ws_size, hipStream_t stream) {
    if (n_in != 42 || (size_t)out_size != O_END || ws_size < WS_END) { fprintf(stderr, "kernel_launch: unexpected sizes n_in %d out %d ws %zu\n", n_in, out_size, ws_size); return; }
    const float* const* in = (const float* const*)d_in;
    unsigned char* ws = (unsigned char*)d_ws; float* out = (float*)d_out;
    bf16_t* WIN0 = (bf16_t*)(ws + WS_WIN0); bf16_t* WOUT0 = (bf16_t*)(ws + WS_WOUT0); bf16_t* WIN1 = (bf16_t*)(ws + WS_WIN1); bf16_t* WOUT1 = (bf16_t*)(ws + WS_WOUT1);
    bf16_t* WGLU = (bf16_t*)(ws + WS_WGLU); bf16_t* WLRU = (bf16_t*)(ws + WS_WLRU);
    bf16_t* FFNIN = (bf16_t*)(ws + WS_FFNIN); bf16_t* FFNOUT = (bf16_t*)(ws + WS_FFNOUT);
    float* MOD = (float*)(ws + WS_MOD); bf16_t* XNY = (bf16_t*)(ws + WS_XNY); bf16_t* Z = (bf16_t*)(ws + WS_Z);
    float* TMPZ = (float*)(ws + WS_Z); float* TMPS = (float*)(ws + WS_SCR);
    k_prep_w<<<1024, 256, 0, stream>>>(in[10], 1024, 2576, WIN0, NIN0, 1);
    k_prep_w<<<1024, 256, 0, stream>>>(in[21], 1024, 1024, WOUT0, 1024, 0);
    k_prep_w<<<1024, 256, 0, stream>>>(in[22], 1024, 2560, WIN1, NIN1, 0);
    k_prep_w<<<1024, 256, 0, stream>>>(in[35], 1024, 1024, WOUT1, 1024, 0);
    k_prep_w<<<256, 256, 0, stream>>>(in[31], 512, 512, WGLU, 512, 0);
    for (int l = 0; l < 2; ++l) {
        k_prep_w<<<1024, 256, 0, stream>>>(in[40] + (size_t)l * 1024 * 5632, 1024, 5632, FFNIN + (size_t)l * 5632 * 1024, 5632, 2);
        k_prep_w<<<1024, 256, 0, stream>>>(in[41] + (size_t)l * 2816 * 1024, 2816, 1024, FFNOUT + (size_t)l * 1024 * 2816, 1024, 0);
    }
    k_prep_lru<<<(2 * 8 * 64 * 64 + 255) / 256, 256, 0, stream>>>(in[16], in[18], WLRU);
    k_mod<<<dim3(6144 / 256, NSEQ / 8, 2), 256, 0, stream>>>(in[2], in[3], in[36], in[37], MOD);
    k_modulate0<<<MPAD, 256, 0, stream>>>(in[0], in[1], MOD, out, XNY);
    MixP p{};
    p.Z = Z; p.Y = XNY; p.out = out;
    p.st_gla = in[4]; p.st_conv = in[5]; p.st_lru = in[6]; p.st_re = in[7]; p.st_im = in[8]; p.st_hg = in[9];
    p.wlr = in[11]; p.blr = in[12]; p.gnorm = in[13]; p.convw = in[14]; p.convb = in[15]; p.wr = in[16]; p.br = in[17]; p.wi = in[18]; p.bi = in[19]; p.lam = in[20];
    p.lam_re = in[23]; p.lam_im = in[24]; p.log_dt = in[25]; p.b_re = in[26]; p.b_im = in[27]; p.c_re = in[28]; p.c_im = in[29]; p.dskip = in[30]; p.wglu = in[31]; p.bglu = in[32];
    p.lblog = in[33]; p.hgnorm = in[34]; p.ypre = (float*)(ws + WS_SCR);
    const float* lng = in[38]; const float* lnb = in[39];
    auto gemm_blocks = [](int M, int N) { return ((M / 32) * (N / 32) + 3) / 4; };
    for (int l = 0; l < 2; ++l) {
        const float* modl = MOD + (size_t)l * NSEQ * 6144;
        if (l == 0) {
            k_gemm_naive<0><<<gemm_blocks(MPAD, NIN0), 256, 0, stream>>>(XNY, WIN0, Z, MPAD, NIN0, 1024, LDZ);
            k_gla_naive<64, 0><<<NSEQ * 4, 128, 0, stream>>>(p);
            k_lru_naive<<<NSEQ * 8, 64, 0, stream>>>(p);
        } else {
            k_gemm_naive<0><<<gemm_blocks(MPAD, NIN1), 256, 0, stream>>>(XNY, WIN1, Z, MPAD, NIN1, 1024, LDZ);
            k_s5_naive<<<NSEQ * 32, 64, 0, stream>>>(p);
            k_glu_naive<<<MT / 8, 256, 0, stream>>>(p);
            k_gla_naive<128, 1><<<NSEQ * 4, 128, 0, stream>>>(p);
        }
        k_gemm_naive<2><<<gemm_blocks(MPAD, 1024), 256, 0, stream>>>(XNY, l == 0 ? WOUT0 : WOUT1, TMPZ, MPAD, 1024, 1024, 1024);
        k_ln_naive<<<MT, 256, 0, stream>>>(TMPZ, out, modl, MOD_GT_M, lng + (l * 2 + 0) * 1024, lnb + (l * 2 + 0) * 1024, XNY, modl, MOD_SC_F, MOD_SH_F);
        k_gemm_naive<1><<<gemm_blocks(MPAD, 5632), 256, 0, stream>>>(XNY, FFNIN + (size_t)l * 5632 * 1024, Z, MPAD, 5632, 1024, LDZ);
        k_gemm_naive<2><<<gemm_blocks(MPAD, 1024), 256, 0, stream>>>(Z, FFNOUT + (size_t)l * 1024 * 2816, TMPS, MPAD, 1024, 2816, 1024);
        const float* modn = l == 0 ? MOD + (size_t)NSEQ * 6144 : nullptr;
        k_ln_naive<<<MT, 256, 0, stream>>>(TMPS, out, modl, MOD_GT_F, lng + (l * 2 + 1) * 1024, lnb + (l * 2 + 1) * 1024, XNY, modn, MOD_SC_M, MOD_SH_M);
    }
}
```
